# Optimizing an MI355X kernel written in HIP

```python
import jax, jax.numpy as jnp
from jax import lax
import numpy as np

D_MODEL = 1024
BATCH = 8
SEQ = 4096
DEPTH = 2

N_HEADS = 16
HEAD_DIM = D_MODEL // N_HEADS
Q_BLOCK = 128
POOL_WINDOWS = (2, 4, 8, 16)
N_POOL_GROUPS = len(POOL_WINDOWS)
POOL_GROUP = D_MODEL // N_POOL_GROUPS
D_FF = 2816
N_MOD = 9
N_MIXERS = 2
N_ATTN_LAYERS = (DEPTH + 1) // 2
N_POOL_LAYERS = DEPTH // 2
EPS = 1e-6

kernel_name = "hybrid_stickbreak_pool_macaron_adaln"


def rmsnorm(x, g):
    xf = x.astype(jnp.float32)
    y = xf * lax.rsqrt(jnp.mean(xf * xf, axis=-1, keepdims=True) + EPS)
    return (y * g.astype(jnp.float32)).astype(x.dtype)


def modulate(h, shift, scale):
    return h * (1.0 + scale[:, None, :]) + shift[:, None, :]


def swiglu(h, w1, w2):
    gate, up = jnp.split(h @ w1, 2, axis=-1)
    return (jax.nn.silu(gate) * up) @ w2


def stick_breaking_attention(h, w_in, w_out):
    b, s_len, d = h.shape
    qkv = (h @ w_in).reshape(b, s_len, 3, N_HEADS, HEAD_DIM)
    q, k, v = qkv[:, :, 0], qkv[:, :, 1], qkv[:, :, 2]
    inv_sqrt_d = 1.0 / float(np.sqrt(HEAD_DIM))
    outs = []
    for qb in range(s_len // Q_BLOCK):
        t0 = qb * Q_BLOCK
        end = t0 + Q_BLOCK
        qi = q[:, t0:end]
        kj = k[:, :end]
        vj = v[:, :end]
        z = jnp.einsum('bqhd,bkhd->bhqk', qi, kj).astype(jnp.float32) * inv_sqrt_d
        t_pos = t0 + jnp.arange(Q_BLOCK)[:, None]
        s_pos = jnp.arange(end)[None, :]
        causal = s_pos < t_pos
        log_beta = jax.nn.log_sigmoid(z)
        log_one_minus = jnp.where(causal, -jax.nn.softplus(z), 0.0)
        shifted = jnp.concatenate([log_one_minus[..., 1:], jnp.zeros_like(log_one_minus[..., :1])], axis=-1)
        suffix = lax.cumsum(shifted, axis=3, reverse=True)
        a = jnp.where(causal, jnp.exp(log_beta + suffix), 0.0)
        outs.append(jnp.einsum('bhqk,bkhd->bqhd', a.astype(v.dtype), vj))
    o = jnp.concatenate(outs, axis=1).reshape(b, s_len, d)
    return o @ w_out


def multiscale_pool_mixer(h, w_in, w_group, scale, w_out):
    b, s_len, d = h.shape
    u = h @ w_in
    uf = u.astype(jnp.float32)
    cs = jnp.concatenate([jnp.zeros((b, 1, d), jnp.float32), jnp.cumsum(uf, axis=1)], axis=1)
    hi = cs[:, 1:]
    pos = jnp.arange(s_len, dtype=jnp.float32)[None, :, None]
    groups = []
    for gi, w in enumerate(POOL_WINDOWS):
        sl = slice(gi * POOL_GROUP, (gi + 1) * POOL_GROUP)
        lo = jnp.pad(cs[:, :, sl], ((0, 0), (w - 1, 0), (0, 0)))[:, :s_len]
        count = jnp.minimum(pos + 1.0, float(w))
        mean = (hi[:, :, sl] - lo) / count
        groups.append(mean - uf[:, :, sl])
    p = jnp.stack(groups, axis=2).astype(h.dtype)
    p = jnp.einsum('bsgc,gce->bsge', p, w_group).reshape(b, s_len, d)
    return (p * scale) @ w_out


def setup_inputs(seed: int = 0) -> dict:
    key = jax.random.key(seed)
    ks = jax.random.split(key, 16)

    def dense(k, shape, fan_in, gain=1.0):
        return jax.random.normal(k, shape, jnp.float32) * (gain * fan_in ** -0.5)

    x = jax.random.normal(ks[0], (BATCH, SEQ, D_MODEL), jnp.float32)
    c = jax.random.normal(ks[1], (BATCH, D_MODEL), jnp.float32)
    mod_w = dense(ks[2], (DEPTH, D_MODEL, N_MOD * D_MODEL), D_MODEL, 0.1)
    mod_b = 0.01 * jax.random.normal(ks[3], (DEPTH, N_MOD * D_MODEL), jnp.float32)
    norm_g = 1.0 + 0.05 * jax.random.normal(ks[4], (DEPTH, 3, D_MODEL), jnp.float32)
    ffn_w1 = dense(ks[5], (DEPTH, 2, D_MODEL, 2 * D_FF), D_MODEL)
    ffn_w2 = dense(ks[6], (DEPTH, 2, D_FF, D_MODEL), D_FF)
    attn_w_in = dense(ks[7], (N_ATTN_LAYERS, D_MODEL, 3 * D_MODEL), D_MODEL)
    attn_w_out = dense(ks[8], (N_ATTN_LAYERS, D_MODEL, D_MODEL), D_MODEL)
    pool_w_in = dense(ks[9], (N_POOL_LAYERS, D_MODEL, D_MODEL), D_MODEL)
    pool_w_group = dense(ks[10], (N_POOL_LAYERS, N_POOL_GROUPS, POOL_GROUP, POOL_GROUP), POOL_GROUP)
    pool_scale = 1.0 + 0.1 * jax.random.normal(ks[11], (N_POOL_LAYERS, D_MODEL), jnp.float32)
    pool_w_out = dense(ks[12], (N_POOL_LAYERS, D_MODEL, D_MODEL), D_MODEL)
    final_norm = 1.0 + 0.05 * jax.random.normal(ks[13], (D_MODEL,), jnp.float32)
    return {"x": x, "c": c, "mod_w": mod_w, "mod_b": mod_b, "norm_g": norm_g,
            "ffn_w1": ffn_w1, "ffn_w2": ffn_w2,
            "attn_w_in": attn_w_in, "attn_w_out": attn_w_out,
            "pool_w_in": pool_w_in, "pool_w_group": pool_w_group,
            "pool_scale": pool_scale, "pool_w_out": pool_w_out,
            "final_norm": final_norm}


def reference(x, c, mod_w, mod_b, norm_g, ffn_w1, ffn_w2, attn_w_in, attn_w_out,
              pool_w_in, pool_w_group, pool_scale, pool_w_out, final_norm):
    b = x.shape[0]
    c_act = jax.nn.silu(c)
    for i in range(DEPTH):
        mod = (c_act @ mod_w[i] + mod_b[i]).reshape(b, N_MOD, D_MODEL)
        sh1, sc1, g1, sh2, sc2, g2, sh3, sc3, g3 = [mod[:, j] for j in range(N_MOD)]
        h = modulate(rmsnorm(x, norm_g[i, 0]), sh1, sc1)
        x = x + 0.5 * (1.0 + g1)[:, None, :] * swiglu(h, ffn_w1[i, 0], ffn_w2[i, 0])
        h = modulate(rmsnorm(x, norm_g[i, 1]), sh2, sc2)
        j = i // N_MIXERS
        if i % N_MIXERS == 0:
            m = stick_breaking_attention(h, attn_w_in[j], attn_w_out[j])
        else:
            m = multiscale_pool_mixer(h, pool_w_in[j], pool_w_group[j], pool_scale[j], pool_w_out[j])
        x = x + (1.0 + g2)[:, None, :] * m
        h = modulate(rmsnorm(x, norm_g[i, 2]), sh3, sc3)
        x = x + 0.5 * (1.0 + g3)[:, None, :] * swiglu(h, ffn_w1[i, 1], ffn_w2[i, 1])
    return rmsnorm(x, final_norm)
```

```cpp
#include <hip/hip_runtime.h>
#include <hip/hip_cooperative_groups.h>
#include <cstdio>
#include <cstdint>
namespace cg = cooperative_groups;
__device__ __forceinline__ int opaque_tid() { int t = threadIdx.x; asm volatile("" : "+v"(t)); return t; }
namespace pg8 {
#define PG8_LAS __attribute__((address_space(3)))
typedef unsigned short bf16_t;
typedef short bf16x8 __attribute__((ext_vector_type(8)));
typedef float f32x4 __attribute__((ext_vector_type(4)));
typedef unsigned u32x4 __attribute__((ext_vector_type(4)));
constexpr int BM = 256, BK = 64, HALF = 128, HTB = HALF * BK * 2  , STAGE_BYTES = 8 * HTB, NXCD = 8, WGM = 8;

__host__ __device__ __forceinline__ int lds_byte(int r, int c) { const int st = (r >> 4) * 2 + (c >> 5), rr = r & 15, cc = c & 31, ob = rr * 64 + cc * 2; return st * 1024 + (ob ^ (((ob >> 9) & 1) << 5)); }
__host__ __device__ __forceinline__ void stage_rc(int b, int& R, int& C) { const int st = b / 1024, sb = b % 1024, swz = sb ^ (((sb >> 9) & 1) << 5); R = (st >> 1) * 16 + swz / 64; C = (st & 1) * 32 + (swz % 64) / 2; }
__host__ __device__ __forceinline__ int perm32(int rho) { const int n = rho >> 4, i = rho & 15; return 8 * (i >> 2) + 4 * n + (i & 3); }

struct Unit { int pm, pn; };
struct Gemm { const bf16_t* A; const bf16_t* Bt; int M, N, K; size_t a_pn; };

struct StaticOrder {
    int nM, nN, nwg, G, c;
    __host__ __device__ void init(int M, int N, int G_, int c_) { nM = M / BM; nN = N / BM; nwg = nM * nN; G = G_; c = c_; }
    __host__ __device__ bool next(int i, Unit& u) const {
        const long L = (long)i * G + c; if (L >= nwg) return false;
        int wgid = (int)L; { const int q = nwg / NXCD, r = nwg % NXCD, xcd = wgid % NXCD, off = wgid / NXCD; wgid = (xcd < r ? xcd * (q + 1) : r * (q + 1) + (xcd - r) * q) + off; }
        const int nig = WGM * nN, gid = wgid / nig, fm = gid * WGM, gsz = (nM - fm) < WGM ? (nM - fm) : WGM;
        u.pm = fm + ((wgid % nig) % gsz); u.pn = (wgid % nig) / gsz; return true;
    }
    __device__ __forceinline__ void a_ready(const Unit&) const {}
    __device__ __forceinline__ void done(const Unit&) const {}
};

__device__ __forceinline__ unsigned cvt_pk_bf16(float lo, float hi) { unsigned r; asm volatile("v_cvt_pk_bf16_f32 %0, %1, %2" : "=v"(r) : "v"(lo), "v"(hi)); return r; }
struct EpiBf16 {
    static constexpr bool PERM = true, AFTER_DRAIN = false;
    bf16_t* O; int ldc;
    __device__ __forceinline__ void operator()(const f32x4 (&acc)[2][2][4][2], const Unit& u, int wr, int wc, int fr, int fq) const {
        const int row0 = u.pm * BM + wr * 64 + fr, col0 = u.pn * BM + wc * 32 + 8 * fq;
#pragma unroll
        for (int ai = 0; ai < 2; ++ai)
#pragma unroll
            for (int m = 0; m < 4; ++m) { bf16_t* rowp = O + (size_t)(row0 + ai * HALF + m * 16) * ldc + col0;
#pragma unroll
                for (int bj = 0; bj < 2; ++bj) { const f32x4 v0 = acc[ai][bj][m][0], v1 = acc[ai][bj][m][1];
                    u32x4 w; w.x = cvt_pk_bf16(v0[0], v0[1]); w.y = cvt_pk_bf16(v0[2], v0[3]); w.z = cvt_pk_bf16(v1[0], v1[1]); w.w = cvt_pk_bf16(v1[2], v1[3]);
                    *(u32x4*)(rowp + bj * HALF) = w; } }
    }
};
__device__ __forceinline__ float silu_mul(float g, float u) { return g * __builtin_amdgcn_rcpf(1.0f + __builtin_amdgcn_exp2f(-1.4426950408889634f * g)) * u; }
struct EpiSwiGLU {
    static constexpr bool PERM = true, AFTER_DRAIN = false;
    bf16_t* O; int ldc;
    __device__ __forceinline__ void operator()(const f32x4 (&acc)[2][2][4][2], const Unit& u, int wr, int wc, int fr, int fq) const {
        const int row0 = u.pm * BM + wr * 64 + fr, col0 = u.pn * HALF + wc * 32 + 8 * fq;
#pragma unroll
        for (int ai = 0; ai < 2; ++ai)
#pragma unroll
            for (int m = 0; m < 4; ++m) { bf16_t* rowp = O + (size_t)(row0 + ai * HALF + m * 16) * ldc + col0;
                const f32x4 g0 = acc[ai][0][m][0], g1 = acc[ai][0][m][1], u0 = acc[ai][1][m][0], u1 = acc[ai][1][m][1];
                u32x4 w; w.x = cvt_pk_bf16(silu_mul(g0[0], u0[0]), silu_mul(g0[1], u0[1])); w.y = cvt_pk_bf16(silu_mul(g0[2], u0[2]), silu_mul(g0[3], u0[3]));
                w.z = cvt_pk_bf16(silu_mul(g1[0], u1[0]), silu_mul(g1[1], u1[1])); w.w = cvt_pk_bf16(silu_mul(g1[2], u1[2]), silu_mul(g1[3], u1[3]));
                *(u32x4*)rowp = w; }
    }
};
struct EpiResid {
    static constexpr bool PERM = false, AFTER_DRAIN = false;
    const float* xin; float* xout; const float* gate; int gpitch; float cs;
    __device__ __forceinline__ void operator()(const f32x4 (&acc)[2][2][4][2], const Unit& u, int wr, int wc, int fr, int fq) const {
        const int row0 = u.pm * BM + wr * 64 + fr, col0 = u.pn * BM + wc * 32 + 4 * fq;
        const float* gp = gate + (size_t)(u.pm >> 4) * gpitch + col0;
        f32x4 cf[2][2];
#pragma unroll
        for (int bj = 0; bj < 2; ++bj)
#pragma unroll
            for (int n = 0; n < 2; ++n) cf[bj][n] = (*(const f32x4*)(gp + bj * HALF + n * 16) + 1.0f) * cs;
#pragma unroll
        for (int ai = 0; ai < 2; ++ai)
#pragma unroll
            for (int m = 0; m < 4; ++m) { const size_t off = (size_t)(row0 + ai * HALF + m * 16) * 1024 + col0;
#pragma unroll
                for (int bj = 0; bj < 2; ++bj)
#pragma unroll
                    for (int n = 0; n < 2; ++n) { const f32x4 xi = *(const f32x4*)(xin + off + bj * HALF + n * 16); *(f32x4*)(xout + off + bj * HALF + n * 16) = xi + cf[bj][n] * acc[ai][bj][m][n]; }
                asm volatile("" ::: "memory"); }
    }
};

template <class Epi, class Sched, bool ALIGN_EPI = false, bool SP2 = false>
__device__ __forceinline__ void gemm_phase(PG8_LAS unsigned char* lds, const Gemm g, const Sched& S, const Epi& E) {
    const int tid = opaque_tid(), wid = __builtin_amdgcn_readfirstlane(tid >> 6), lane = tid & 63, wr = wid >> 2, wc = wid & 3, fr = lane & 15, fq = lane >> 4;
    const int K = g.K, nt = K / BK;
    unsigned voffA[2], voffB[2];
#pragma unroll
    for (int i = 0; i < 2; ++i) { int R, C; stage_rc(tid * 16 + i * 8192, R, C); const int Rb = Epi::PERM ? ((R & ~31) + perm32(R & 31)) : R;
        voffA[i] = (unsigned)(R * K + C) * 2u; voffB[i] = (unsigned)(Rb * K + C) * 2u; }
    const size_t kstep = (size_t)(BK * 2);
    const size_t hstep = (size_t)HALF * K * 2;
    const size_t tstep = 2 * hstep;
    const unsigned ldsw = (unsigned)wid * 1024u;
    const int aoff = lds_byte(wr * 64 + fr, fq * 8), boff = lds_byte(wc * 32 + fr, fq * 8);
#define PG8_SA(b, h) (((b) * 2 + (h)) * HTB)
#define PG8_SB(b, h) ((4 + (b) * 2 + (h)) * HTB)
#define PG8_STAGE(bufoff, gbase, voff) do { _Pragma("unroll") for (int _i = 0; _i < 2; ++_i) \
        __builtin_amdgcn_global_load_lds((const unsigned*)((const char*)(gbase) + (voff)[_i]), (PG8_LAS unsigned*)(lds + (bufoff) + ldsw + _i * 8192), 16, 0, 0); } while (0)
#define PG8_LDA(dst, b, h) do { _Pragma("unroll") for (int m = 0; m < 4; ++m) _Pragma("unroll") for (int k = 0; k < 2; ++k) dst[m][k] = *(const PG8_LAS bf16x8*)(lds + PG8_SA(b, h) + aoff + m * 2048 + k * 1024); } while (0)
#define PG8_LDB(dst, b, h) do { _Pragma("unroll") for (int n = 0; n < 2; ++n) _Pragma("unroll") for (int k = 0; k < 2; ++k) dst[n][k] = *(const PG8_LAS bf16x8*)(lds + PG8_SB(b, h) + boff + n * 2048 + k * 1024); } while (0)
#define PG8_MMA(ai, bj, At, Bt) do { __builtin_amdgcn_s_setprio(1); _Pragma("unroll") for (int m = 0; m < 4; ++m) _Pragma("unroll") for (int n = 0; n < 2; ++n) _Pragma("unroll") for (int k = 0; k < 2; ++k) \
        acc[ai][bj][m][n] = __builtin_amdgcn_mfma_f32_16x16x32_bf16(Bt[n][k], At[m][k], acc[ai][bj][m][n], 0, 0, 0); __builtin_amdgcn_s_setprio(0); } while (0)
#define PG8_WAIT_V(n) asm volatile("s_waitcnt vmcnt(" #n ")" ::: "memory")
#define PG8_WAIT_L(n) asm volatile("s_waitcnt lgkmcnt(" #n ")" ::: "memory")
#define PG8_BAR __builtin_amdgcn_s_barrier()
#define PG8_SCHED __builtin_amdgcn_sched_barrier(0)
    Unit cur, nxt; int ui = 0;
    if (!S.next(0, cur)) return;
    f32x4 acc[2][2][4][2];
#pragma unroll
    for (int a = 0; a < 2; ++a)
#pragma unroll
        for (int b = 0; b < 2; ++b)
#pragma unroll
            for (int m = 0; m < 4; ++m)
#pragma unroll
                for (int n = 0; n < 2; ++n) acc[a][b][m][n] = (f32x4){0.f, 0.f, 0.f, 0.f};
    bf16x8 At[4][2], B0[2][2], B1[2][2];
    const char* cA = (const char*)g.A + (size_t)cur.pm * tstep + (size_t)cur.pn * g.a_pn; const char* cB = (const char*)g.Bt + (size_t)cur.pn * tstep;
    S.a_ready(cur);
    if constexpr (SP2) {
        PG8_STAGE(PG8_SB(0, 0), cB, voffB); PG8_STAGE(PG8_SB(0, 1), cB + hstep, voffB); PG8_STAGE(PG8_SA(0, 0), cA, voffA); PG8_STAGE(PG8_SA(0, 1), cA + hstep, voffA);
        if (wr == 1) PG8_BAR;
        PG8_WAIT_V(2); PG8_BAR;
        PG8_STAGE(PG8_SB(1, 0), cB + kstep, voffB); PG8_STAGE(PG8_SA(1, 0), cA + kstep, voffA); PG8_STAGE(PG8_SB(1, 1), cB + hstep + kstep, voffB);
        PG8_WAIT_V(6); PG8_BAR;
    } else {
        PG8_STAGE(PG8_SB(0, 0), cB, voffB); PG8_STAGE(PG8_SA(0, 0), cA, voffA); PG8_STAGE(PG8_SB(0, 1), cB + hstep, voffB); PG8_STAGE(PG8_SA(0, 1), cA + hstep, voffA);
        if (wr == 1) PG8_BAR;
        PG8_WAIT_V(4); PG8_BAR;
        PG8_STAGE(PG8_SB(1, 0), cB + kstep, voffB); PG8_STAGE(PG8_SA(1, 0), cA + kstep, voffA); PG8_STAGE(PG8_SB(1, 1), cB + hstep + kstep, voffB);
        PG8_WAIT_V(6); PG8_BAR;
    }
    for (;;) {
        const bool has_next = S.next(ui + 1, nxt);
        const char* nA = has_next ? (const char*)g.A + (size_t)nxt.pm * tstep + (size_t)nxt.pn * g.a_pn : cA; const char* nB = has_next ? (const char*)g.Bt + (size_t)nxt.pn * tstep : cB;
        for (int t = 0; t < nt; t += 2) {
            const bool last = (t == nt - 2);
            const char* a1 = cA + (size_t)(t + 1) * kstep;
            const char* a2 = last ? nA : cA + (size_t)(t + 2) * kstep; const char* b2 = last ? nB : cB + (size_t)(t + 2) * kstep;
            const char* a3 = a2 + kstep; const char* b3 = b2 + kstep;
            if (last && has_next) S.a_ready(nxt);
            if constexpr (SP2) {
            PG8_LDB(B0, 0, 0); PG8_LDB(B1, 0, 1); PG8_SCHED; PG8_LDA(At, 0, 0); PG8_STAGE(PG8_SA(1, 1), a1 + hstep, voffA);
            PG8_WAIT_V(8); PG8_WAIT_L(0); PG8_BAR; PG8_MMA(0, 0, At, B0); PG8_MMA(0, 1, At, B1); PG8_BAR; PG8_SCHED;
            PG8_LDA(At, 0, 1); PG8_STAGE(PG8_SB(0, 0), b2, voffB); PG8_STAGE(PG8_SB(0, 1), b2 + hstep, voffB); PG8_STAGE(PG8_SA(0, 0), a2, voffA);
            PG8_WAIT_V(8); PG8_WAIT_L(0); PG8_BAR; PG8_MMA(1, 0, At, B0); PG8_MMA(1, 1, At, B1); PG8_BAR; PG8_SCHED;
            PG8_LDB(B0, 1, 0); PG8_LDB(B1, 1, 1); PG8_SCHED; PG8_LDA(At, 1, 0); PG8_STAGE(PG8_SA(0, 1), a2 + hstep, voffA);
            PG8_WAIT_V(8); PG8_WAIT_L(0); PG8_BAR; PG8_MMA(0, 0, At, B0); PG8_MMA(0, 1, At, B1); PG8_BAR; PG8_SCHED;
            PG8_LDA(At, 1, 1); PG8_STAGE(PG8_SB(1, 0), b3, voffB); PG8_STAGE(PG8_SB(1, 1), b3 + hstep, voffB); PG8_STAGE(PG8_SA(1, 0), a3, voffA);
            PG8_WAIT_V(8); PG8_WAIT_L(0); PG8_BAR; PG8_MMA(1, 0, At, B0); PG8_MMA(1, 1, At, B1); PG8_BAR; PG8_SCHED;
            } else {
            PG8_LDB(B0, 0, 0); PG8_SCHED; PG8_LDA(At, 0, 0); PG8_STAGE(PG8_SA(1, 1), a1 + hstep, voffA);
            PG8_WAIT_L(8); PG8_BAR; PG8_WAIT_L(0); PG8_MMA(0, 0, At, B0); PG8_BAR; PG8_SCHED;
            PG8_LDB(B1, 0, 1); PG8_STAGE(PG8_SB(0, 0), b2, voffB);
            PG8_BAR; PG8_WAIT_L(0); PG8_MMA(0, 1, At, B1); PG8_BAR;
            PG8_LDA(At, 0, 1); PG8_STAGE(PG8_SA(0, 0), a2, voffA);
            PG8_BAR; PG8_WAIT_L(0); PG8_MMA(1, 0, At, B0); PG8_BAR; PG8_SCHED;
            PG8_STAGE(PG8_SB(0, 1), b2 + hstep, voffB);
            PG8_WAIT_V(6); PG8_BAR; PG8_MMA(1, 1, At, B1); PG8_BAR;
            PG8_LDB(B0, 1, 0); PG8_SCHED; PG8_LDA(At, 1, 0); PG8_STAGE(PG8_SA(0, 1), a2 + hstep, voffA);
            PG8_WAIT_L(8); PG8_BAR; PG8_WAIT_L(0); PG8_MMA(0, 0, At, B0); PG8_BAR; PG8_SCHED;
            PG8_LDB(B1, 1, 1); PG8_STAGE(PG8_SB(1, 0), b3, voffB);
            PG8_BAR; PG8_WAIT_L(0); PG8_MMA(0, 1, At, B1); PG8_BAR;
            PG8_LDA(At, 1, 1); PG8_STAGE(PG8_SA(1, 0), a3, voffA);
            PG8_BAR; PG8_WAIT_L(0); PG8_MMA(1, 0, At, B0); PG8_BAR; PG8_SCHED;
            PG8_STAGE(PG8_SB(1, 1), b3 + hstep, voffB);
            PG8_WAIT_V(6); PG8_BAR; PG8_MMA(1, 1, At, B1); PG8_BAR;
            }
        }
        if constexpr (ALIGN_EPI) { if (wr == 0) PG8_BAR; }
        if constexpr (!Epi::AFTER_DRAIN) { E(acc, cur, wr, wc, fr, fq); S.done(cur); }
        if (!has_next) break;
#pragma unroll
        for (int a = 0; a < 2; ++a)
#pragma unroll
            for (int b = 0; b < 2; ++b)
#pragma unroll
                for (int m = 0; m < 4; ++m)
#pragma unroll
                    for (int n = 0; n < 2; ++n) acc[a][b][m][n] = (f32x4){0.f, 0.f, 0.f, 0.f};
        cur = nxt; cA = nA; cB = nB; ++ui;
        if constexpr (ALIGN_EPI) { if (wr == 1) PG8_BAR; }
    }
    PG8_WAIT_V(0);
    if constexpr (!ALIGN_EPI) { if (wr == 0) PG8_BAR; }
    PG8_BAR;
    if constexpr (Epi::AFTER_DRAIN) { E.fused(acc, cur, wr, wc, fr, fq, lds, wid, lane); S.done(cur); }
#undef PG8_SA
#undef PG8_SB
#undef PG8_STAGE
#undef PG8_LDA
#undef PG8_LDB
#undef PG8_MMA
#undef PG8_WAIT_V
#undef PG8_WAIT_L
#undef PG8_BAR
#undef PG8_SCHED
}
}

#define LAS __attribute__((address_space(3)))
typedef unsigned short bf16;
typedef short bf16x8 __attribute__((ext_vector_type(8)));
typedef float f32x4 __attribute__((ext_vector_type(4)));
typedef float f32x16 __attribute__((ext_vector_type(16)));
typedef unsigned u32x4 __attribute__((ext_vector_type(4)));
typedef unsigned u32x2 __attribute__((ext_vector_type(2)));
constexpr int NB = 8, SEQ = 4096, D = 1024, M = NB * SEQ, FF = 2816, NQKV = 3072, NMODC = 9 * D;
constexpr size_t MiB = 1024 * 1024;
constexpr size_t WS_MOD = 0, WS_W1 = 1 * MiB, WS_W2 = WS_W1 + 44 * MiB, WS_WQKV = WS_W2 + 22 * MiB, WS_WO = WS_WQKV + 6 * MiB, WS_PIN = WS_WO + 2 * MiB, WS_PG = WS_PIN + 2 * MiB,
                 WS_POUT = WS_PG + 1 * MiB, WS_H = WS_POUT + 2 * MiB, WS_BIG = WS_H + 64 * MiB, WS_END = WS_BIG + 192 * MiB;
constexpr int LDS_BYTES = 139264;
constexpr float ATT_STOP = -50.0f;

struct Params {
    const float *x, *c, *mod_w, *mod_b, *norm_g, *ffn_w1, *ffn_w2, *attn_w_in, *attn_w_out, *pool_w_in, *pool_w_group, *pool_scale, *pool_w_out, *final_norm;
    float* out; unsigned char* ws; int ph_lo, ph_hi;
};

__device__ __forceinline__ unsigned pk_bf16(float lo, float hi) { return pg8::cvt_pk_bf16(lo, hi); }
__device__ __forceinline__ float bf2f(unsigned short v) { return __uint_as_float(((unsigned)v) << 16); }

__device__ __forceinline__ void tr_tile(LAS float* tile, const float* src, int src_ld, bf16* dst, int dst_ld, const float* kscale, int lane) {
#pragma unroll
    for (int i = 0; i < 16; ++i) { const int kk = i * 4 + (lane >> 4), nn = (lane & 15) * 4;
        f32x4 v = *(const f32x4*)(src + (size_t)kk * src_ld + nn);
        if (kscale) v = v * kscale[kk];
        tile[kk * 65 + nn + 0] = v[0]; tile[kk * 65 + nn + 1] = v[1]; tile[kk * 65 + nn + 2] = v[2]; tile[kk * 65 + nn + 3] = v[3]; }
    asm volatile("s_waitcnt lgkmcnt(0)" ::: "memory"); __builtin_amdgcn_wave_barrier();
#pragma unroll
    for (int j = 0; j < 8; ++j) { const int nn = j * 8 + (lane >> 3), kb = (lane & 7) * 8;
        float e[8];
#pragma unroll
        for (int q = 0; q < 8; ++q) e[q] = tile[(kb + q) * 65 + nn];
        u32x4 w; w.x = pk_bf16(e[0], e[1]); w.y = pk_bf16(e[2], e[3]); w.z = pk_bf16(e[4], e[5]); w.w = pk_bf16(e[6], e[7]);
        *(u32x4*)(dst + (size_t)nn * dst_ld + kb) = w; }
    asm volatile("s_waitcnt lgkmcnt(0)" ::: "memory"); __builtin_amdgcn_wave_barrier();
}

__device__ __forceinline__ void prep_phase(const Params& p, LAS unsigned char* lds) {
    const int tid = opaque_tid(), lane = tid & 63, wave = tid >> 6;
    LAS float* cact = (LAS float*)lds;
    LAS float* red = (LAS float*)(lds + 32768);
    for (int i = tid; i < NB * D; i += 512) { const float v = p.c[i]; cact[i] = v / (1.0f + __expf(-v)); }
    __syncthreads();
    float* MOD = (float*)(p.ws + WS_MOD);
    for (int task = blockIdx.x; task < 288; task += gridDim.x) {
        const int layer = task / 144, col0 = (task % 144) * 64;
        const float* w = p.mod_w + (size_t)layer * D * NMODC + col0 + lane;
        float a[8] = {0.f, 0.f, 0.f, 0.f, 0.f, 0.f, 0.f, 0.f};
        const int k0 = wave * 128;
#pragma unroll 8
        for (int k = k0; k < k0 + 128; ++k) { const float wv = w[(size_t)k * NMODC];
#pragma unroll
            for (int b = 0; b < 8; ++b) a[b] += cact[b * D + k] * wv; }
#pragma unroll
        for (int b = 0; b < 8; ++b) red[(wave * 8 + b) * 64 + lane] = a[b];
        __syncthreads();
        { const int b = tid >> 6; float s = 0.f;
#pragma unroll
          for (int w8 = 0; w8 < 8; ++w8) s += red[(w8 * 8 + b) * 64 + lane];
          MOD[(size_t)(layer * 8 + b) * NMODC + col0 + lane] = s + p.mod_b[layer * NMODC + col0 + lane]; }
        __syncthreads();
    }
    __syncthreads();
    LAS float* tile = (LAS float*)(lds + wave * 16640);
    const int gw = blockIdx.x * 8 + wave, nw = gridDim.x * 8;
    constexpr int T_W1 = 4 * 16 * 88, T_W2 = 4 * 44 * 16, T_QKV = 16 * 48, T_SQ = 256, T_PG = 64;
    constexpr int O_W2 = T_W1, O_QKV = O_W2 + T_W2, O_WO = O_QKV + T_QKV, O_PIN = O_WO + T_SQ, O_POUT = O_PIN + T_SQ, O_PG = O_POUT + T_SQ, T_ALL = O_PG + T_PG;
    for (int t = gw; t < T_ALL; t += nw) {
        const float* src; bf16* dst; int sld, dld; const float* ksc = nullptr;
        if (t < O_W2) { const int mat = t / 1408, r = t % 1408, kt = r / 88, nt = r % 88;
            const int n0 = nt * 64, pn = n0 >> 8, wi = n0 & 255, scol = (wi < 128) ? (128 * pn + wi) : (FF + 128 * pn + wi - 128);
            src = p.ffn_w1 + (size_t)mat * D * 2 * FF + (size_t)(kt * 64) * (2 * FF) + scol; sld = 2 * FF;
            dst = (bf16*)(p.ws + WS_W1) + (size_t)mat * 2 * FF * D + (size_t)n0 * D + kt * 64; dld = D; }
        else if (t < O_QKV) { const int q = t - O_W2, mat = q / 704, r = q % 704, kt = r / 16, nt = r % 16;
            src = p.ffn_w2 + (size_t)mat * FF * D + (size_t)(kt * 64) * D + nt * 64; sld = D;
            dst = (bf16*)(p.ws + WS_W2) + (size_t)mat * D * FF + (size_t)(nt * 64) * FF + kt * 64; dld = FF; }
        else if (t < O_WO) { const int q = t - O_QKV, kt = q / 48, nt = q % 48;
            src = p.attn_w_in + (size_t)(kt * 64) * NQKV + nt * 64; sld = NQKV; dst = (bf16*)(p.ws + WS_WQKV) + (size_t)(nt * 64) * D + kt * 64; dld = D; }
        else if (t < O_PG) { const int q = t - O_WO, which = q >> 8, r = q & 255, kt = r >> 4, nt = r & 15;
            const float* s0 = which == 0 ? p.attn_w_out : (which == 1 ? p.pool_w_in : p.pool_w_out);
            const size_t d0 = which == 0 ? WS_WO : (which == 1 ? WS_PIN : WS_POUT);
            if (which == 2) ksc = p.pool_scale + kt * 64;
            src = s0 + (size_t)(kt * 64) * D + nt * 64; sld = D; dst = (bf16*)(p.ws + d0) + (size_t)(nt * 64) * D + kt * 64; dld = D; }
        else { const int q = t - O_PG, g = q >> 4, r = q & 15, kt = r >> 2, nt = r & 3;
            src = p.pool_w_group + (size_t)g * 65536 + (size_t)(kt * 64) * 256 + nt * 64; sld = 256;
            dst = (bf16*)(p.ws + WS_PG) + (size_t)(g * 256 + nt * 64) * 256 + kt * 64; dld = 256; }
        tr_tile(tile, src, sld, dst, dld, ksc, lane);
    }
}

template <bool FINAL>
__device__ __forceinline__ void norm_phase(const float* xin, bf16* H, float* fout, const float* g, const float* sh, const float* sc) {
    const int tid = opaque_tid(), lane = tid & 63, wave = tid >> 6;
    const int gw = blockIdx.x * 8 + wave, nw = gridDim.x * 8;
    for (int chunk = gw; chunk < M / 16; chunk += nw) {
        const int row0 = chunk * 16, b = row0 >> 12;
        f32x4 gm[4], sv[4];
#pragma unroll
        for (int i = 0; i < 4; ++i) { const int c = i * 256 + lane * 4; gm[i] = *(const f32x4*)(g + c);
            if (!FINAL) { gm[i] = gm[i] * (*(const f32x4*)(sc + (size_t)b * NMODC + c) + 1.0f); sv[i] = *(const f32x4*)(sh + (size_t)b * NMODC + c); } }
#pragma unroll 2
        for (int r = 0; r < 16; ++r) {
            const float* xr = xin + (size_t)(row0 + r) * D + lane * 4;
            f32x4 v[4]; float ss = 0.f;
#pragma unroll
            for (int i = 0; i < 4; ++i) { v[i] = *(const f32x4*)(xr + i * 256); ss += (v[i][0] * v[i][0] + v[i][1] * v[i][1]) + (v[i][2] * v[i][2] + v[i][3] * v[i][3]); }
#pragma unroll
            for (int o = 32; o >= 1; o >>= 1) ss += __shfl_xor(ss, o);
            const float rinv = rsqrtf(ss * (1.0f / D) + 1e-6f);
#pragma unroll
            for (int i = 0; i < 4; ++i) {
                if (FINAL) { *(f32x4*)(fout + (size_t)(row0 + r) * D + lane * 4 + i * 256) = v[i] * rinv * gm[i]; }
                else { const f32x4 h = v[i] * rinv * gm[i] + sv[i]; u32x2 w; w.x = pk_bf16(h[0], h[1]); w.y = pk_bf16(h[2], h[3]);
                    *(u32x2*)(H + (size_t)(row0 + r) * D + lane * 4 + i * 256) = w; } }
        }
    }
}

__device__ __forceinline__ void attn_phase(const bf16* QKV, bf16* O) {
    const int tid = opaque_tid(), lane = tid & 63, wave = tid >> 6, r = lane & 31, half = lane >> 5;
    const int gw = blockIdx.x * 8 + wave, nw = gridDim.x * 8;
    for (int unit = gw; unit < NB * 16 * (SEQ / 32); unit += nw) {
        const int h = unit & 15, tq = unit >> 4, b = tq >> 7, t0 = (tq & 127) * 32;
        const size_t rowbase = (size_t)b * SEQ;
        const bf16* qrow = QKV + (rowbase + t0 + r) * NQKV + h * 64 + half * 8;
        bf16x8 qf[4];
#pragma unroll
        for (int kk = 0; kk < 4; ++kk) qf[kk] = *(const bf16x8*)(qrow + kk * 16);
        f32x16 o0, o1;
#pragma unroll
        for (int i = 0; i < 16; ++i) { o0[i] = 0.f; o1[i] = 0.f; }
        float carry = 0.f;
        for (int s0 = t0; s0 >= 0; s0 -= 32) {
            const bf16* krow = QKV + (rowbase + s0 + r) * NQKV + D + h * 64 + half * 8;
            bf16x8 kf[4];
#pragma unroll
            for (int kk = 0; kk < 4; ++kk) kf[kk] = *(const bf16x8*)(krow + kk * 16);
            const bf16* vb = QKV + (rowbase + s0 + 4 * half) * NQKV + 2 * D + h * 64 + r;
            bf16x8 vf[2][2];
#pragma unroll
            for (int kk2 = 0; kk2 < 2; ++kk2)
#pragma unroll
                for (int dd = 0; dd < 2; ++dd)
#pragma unroll
                    for (int e = 0; e < 8; ++e) { const int key = 16 * kk2 + (e < 4 ? e : 4 + e); vf[kk2][dd][e] = (short)vb[(size_t)key * NQKV + 32 * dd]; }
            f32x16 s;
#pragma unroll
            for (int i = 0; i < 16; ++i) s[i] = 0.f;
#pragma unroll
            for (int kk = 0; kk < 4; ++kk) s = __builtin_amdgcn_mfma_f32_32x32x16_bf16(kf[kk], qf[kk], s, 0, 0, 0);
            const bool diag = (s0 == t0);
            float lb[16], lm[16];
#pragma unroll
            for (int i = 0; i < 16; ++i) { const float z = s[i] * 0.125f; const float l = __logf(1.0f + __expf(-fabsf(z)));
                const float m1 = -(fmaxf(z, 0.f) + l);
                const bool valid = !diag || (8 * (i >> 2) + 4 * half + (i & 3) < r);
                lb[i] = valid ? (m1 + z) : -1e30f;
                lm[i] = valid ? m1 : 0.f; }
            float T[4], Tp[4], c[16];
#pragma unroll
            for (int g = 0; g < 4; ++g) { c[4 * g + 3] = 0.f; c[4 * g + 2] = lm[4 * g + 3]; c[4 * g + 1] = c[4 * g + 2] + lm[4 * g + 2]; c[4 * g] = c[4 * g + 1] + lm[4 * g + 1]; T[g] = c[4 * g] + lm[4 * g]; }
#pragma unroll
            for (int g = 0; g < 4; ++g) Tp[g] = __shfl_xor(T[g], 32);
            float A[4]; A[3] = carry; A[2] = A[3] + (T[3] + Tp[3]); A[1] = A[2] + (T[2] + Tp[2]); A[0] = A[1] + (T[1] + Tp[1]);
            const float ncarry = A[0] + (T[0] + Tp[0]);
            float a[16];
#pragma unroll
            for (int i = 0; i < 16; ++i) { const int g = i >> 2; const float suf = A[g] + (half == 0 ? Tp[g] : 0.f) + c[i]; a[i] = __expf(lb[i] + suf); }
            carry = ncarry;
            bf16x8 pf[2];
#pragma unroll
            for (int kk2 = 0; kk2 < 2; ++kk2) { u32x4 w; w.x = pk_bf16(a[8 * kk2 + 0], a[8 * kk2 + 1]); w.y = pk_bf16(a[8 * kk2 + 2], a[8 * kk2 + 3]); w.z = pk_bf16(a[8 * kk2 + 4], a[8 * kk2 + 5]); w.w = pk_bf16(a[8 * kk2 + 6], a[8 * kk2 + 7]);
                pf[kk2] = __builtin_bit_cast(bf16x8, w); }
#pragma unroll
            for (int kk2 = 0; kk2 < 2; ++kk2) { o0 = __builtin_amdgcn_mfma_f32_32x32x16_bf16(vf[kk2][0], pf[kk2], o0, 0, 0, 0); o1 = __builtin_amdgcn_mfma_f32_32x32x16_bf16(vf[kk2][1], pf[kk2], o1, 0, 0, 0); }
            if (__ballot(carry > ATT_STOP) == 0ull) break;
        }
        bf16* orow = O + (rowbase + t0 + r) * D + h * 64 + 4 * half;
#pragma unroll
        for (int g = 0; g < 4; ++g) { u32x2 w0, w1; w0.x = pk_bf16(o0[4 * g], o0[4 * g + 1]); w0.y = pk_bf16(o0[4 * g + 2], o0[4 * g + 3]); w1.x = pk_bf16(o1[4 * g], o1[4 * g + 1]); w1.y = pk_bf16(o1[4 * g + 2], o1[4 * g + 3]);
            *(u32x2*)(orow + 8 * g) = w0; *(u32x2*)(orow + 32 + 8 * g) = w1; }
    }
}

__device__ __forceinline__ void pool_phase(const bf16* U, bf16* P) {
    const int tid = opaque_tid(), c8 = (tid & 127) * 8, gi = c8 >> 8, w = 2 << gi;
    for (int chunk = blockIdx.x * 4 + (tid >> 7); chunk < M / 32; chunk += gridDim.x * 4) {
        const int t_start = chunk * 32, pos0 = t_start & (SEQ - 1);
        float s[8] = {0.f, 0.f, 0.f, 0.f, 0.f, 0.f, 0.f, 0.f};
        for (int i = 1; i <= w; ++i) if (pos0 - i >= 0) { const u32x4 q = *(const u32x4*)(U + (size_t)(t_start - i) * D + c8);
#pragma unroll
            for (int j = 0; j < 4; ++j) { s[2 * j] += __uint_as_float(q[j] << 16); s[2 * j + 1] += __uint_as_float(q[j] & 0xffff0000u); } }
        bf16* pd = P + (size_t)gi * M * 256 + (size_t)t_start * 256 + (c8 & 255);
#pragma unroll 4
        for (int tt = 0; tt < 32; ++tt) {
            const int pos = pos0 + tt;
            const u32x4 q = *(const u32x4*)(U + (size_t)(t_start + tt) * D + c8);
            float u[8];
#pragma unroll
            for (int j = 0; j < 4; ++j) { u[2 * j] = __uint_as_float(q[j] << 16); u[2 * j + 1] = __uint_as_float(q[j] & 0xffff0000u); s[2 * j] += u[2 * j]; s[2 * j + 1] += u[2 * j + 1]; }
            if (pos >= w) { const u32x4 qo = *(const u32x4*)(U + (size_t)(t_start + tt - w) * D + c8);
#pragma unroll
                for (int j = 0; j < 4; ++j) { s[2 * j] -= __uint_as_float(qo[j] << 16); s[2 * j + 1] -= __uint_as_float(qo[j] & 0xffff0000u); } }
            const float inv = 1.0f / (float)(pos + 1 < w ? pos + 1 : w);
            u32x4 o;
#pragma unroll
            for (int j = 0; j < 4; ++j) o[j] = pk_bf16(s[2 * j] * inv - u[2 * j], s[2 * j + 1] * inv - u[2 * j + 1]);
            *(u32x4*)(pd + (size_t)tt * 256) = o;
        }
    }
}

enum { T_PREP = 0, T_NORM, T_UP, T_DOWN, T_QKV, T_ATTN, T_OUT, T_PIN, T_POOL, T_PG, T_POUT, T_FINAL };
constexpr int NSTEPS = 23;
__device__ __forceinline__ void decode_step(int step, int& type, int& layer, int& sub) {
    layer = 0; sub = 0;
    if (step == 0) { type = T_PREP; return; }
    if (step == NSTEPS - 1) { type = T_FINAL; return; }
    layer = step >= 11 ? 1 : 0; const int s = step - (layer ? 11 : 1);
    if (s < 3) { sub = 0; type = s == 0 ? T_NORM : (s == 1 ? T_UP : T_DOWN); return; }
    if (!layer) { if (s < 7) { sub = 1; type = s == 3 ? T_NORM : (s == 4 ? T_QKV : (s == 5 ? T_ATTN : T_OUT)); } else { sub = 2; type = s == 7 ? T_NORM : (s == 8 ? T_UP : T_DOWN); } }
    else { if (s < 8) { sub = 1; type = s == 3 ? T_NORM : (s == 4 ? T_PIN : (s == 5 ? T_POOL : (s == 6 ? T_PG : T_POUT))); } else { sub = 2; type = s == 8 ? T_NORM : (s == 9 ? T_UP : T_DOWN); } }
}

__global__ void __launch_bounds__(512, 2) fwd_megakernel(Params p) {
    extern __shared__ __attribute__((aligned(16))) unsigned char lds_raw[];
    LAS unsigned char* lds = (LAS unsigned char*)lds_raw;
    cg::grid_group grid = cg::this_grid();
    unsigned char* ws = p.ws;
    float* MOD = (float*)(ws + WS_MOD);
    bf16* H = (bf16*)(ws + WS_H); bf16* BIG = (bf16*)(ws + WS_BIG);
    float* X = p.out;
    const int G = gridDim.x, bx = blockIdx.x;
    for (int step = p.ph_lo; step < p.ph_hi; ++step) {
        int type, layer, sub; decode_step(step, type, layer, sub);
        const float* modl = MOD + (size_t)layer * NB * NMODC;
        const float* xin = (layer == 0 && sub == 0) ? p.x : X;
        if (type == T_PREP) prep_phase(p, lds);
        else if (type == T_NORM) norm_phase<false>(xin, H, nullptr, p.norm_g + (layer * 3 + sub) * D, modl + (sub * 3) * D, modl + (sub * 3 + 1) * D);
        else if (type == T_FINAL) norm_phase<true>(X, nullptr, p.out, p.final_norm, nullptr, nullptr);
        else if (type == T_UP) {
            pg8::Gemm g{H, (const bf16*)(ws + WS_W1) + (size_t)(layer * 2 + (sub >> 1)) * 2 * FF * D, M, 2 * FF, D, 0};
            pg8::StaticOrder S; S.init(M, 2 * FF, G, bx); pg8::EpiSwiGLU E{BIG, FF};
            pg8::gemm_phase<pg8::EpiSwiGLU, pg8::StaticOrder, true, true>(lds, g, S, E);
        } else if (type == T_DOWN || type == T_OUT || type == T_POUT) {
            const bf16* A = type == T_DOWN ? BIG : H;
            const bf16* Bt = type == T_DOWN ? (const bf16*)(ws + WS_W2) + (size_t)(layer * 2 + (sub >> 1)) * D * FF : (const bf16*)(ws + (type == T_OUT ? WS_WO : WS_POUT));
            pg8::Gemm g{A, Bt, M, D, type == T_DOWN ? FF : D, 0};
            pg8::StaticOrder S; S.init(M, D, G, bx); pg8::EpiResid E{xin, X, modl + (sub * 3 + 2) * D, NMODC, type == T_DOWN ? 0.5f : 1.0f};
            pg8::gemm_phase<pg8::EpiResid, pg8::StaticOrder, true, true>(lds, g, S, E);
        } else if (type == T_QKV || type == T_PIN || type == T_PG) {
            const bf16* A = type == T_PG ? BIG + (size_t)M * D : H;
            const bf16* Bt = (const bf16*)(ws + (type == T_QKV ? WS_WQKV : (type == T_PIN ? WS_PIN : WS_PG)));
            const int N = type == T_QKV ? NQKV : D, K = type == T_PG ? 256 : D;
            pg8::Gemm g{A, Bt, M, N, K, type == T_PG ? (size_t)M * 256 * 2 : (size_t)0};
            pg8::StaticOrder S; S.init(M, N, G, bx); pg8::EpiBf16 E{type == T_PG ? H : BIG, N};
            pg8::gemm_phase<pg8::EpiBf16, pg8::StaticOrder, true, true>(lds, g, S, E);
        } else if (type == T_ATTN) attn_phase(BIG, H);
        else if (type == T_POOL) pool_phase(BIG, BIG + (size_t)M * D);
        if (step + 1 < p.ph_hi) grid.sync();
    }
}

#ifndef MK_SPLIT
#define MK_SPLIT 0
#endif
extern "C" void kernel_launch(void* const* d_in, const int* in_sizes, int n_in, void* d_out, int out_size, void* d_ws, size_t ws_size, hipStream_t stream) {
    static int grid = 0;
    if (grid == 0) {
        if (n_in != 14 || out_size != M * D || ws_size < WS_END) { fprintf(stderr, "kernel_launch: unexpected shapes (n_in %d out %d ws %zu)\n", n_in, out_size, ws_size); grid = -1; return; }
        int dev = 0, cus = 0, per_cu = 0;
        hipGetDevice(&dev); hipDeviceGetAttribute(&cus, hipDeviceAttributeMultiprocessorCount, dev);
        if (hipFuncSetAttribute((const void*)fwd_megakernel, hipFuncAttributeMaxDynamicSharedMemorySize, LDS_BYTES) != hipSuccess) { fprintf(stderr, "kernel_launch: hipFuncSetAttribute failed\n"); grid = -1; return; }
        if (hipOccupancyMaxActiveBlocksPerMultiprocessor(&per_cu, (const void*)fwd_megakernel, 512, LDS_BYTES) != hipSuccess || per_cu < 1) { fprintf(stderr, "kernel_launch: occupancy query says %d\n", per_cu); per_cu = 1; }
        (void)hipGetLastError();
        grid = cus * 1;
        fprintf(stderr, "kernel_launch: grid %d (cus %d, per_cu %d)\n", grid, cus, per_cu);
    }
    if (grid < 0) return;
    Params p{};
    p.x = (const float*)d_in[0]; p.c = (const float*)d_in[1]; p.mod_w = (const float*)d_in[2]; p.mod_b = (const float*)d_in[3]; p.norm_g = (const float*)d_in[4];
    p.ffn_w1 = (const float*)d_in[5]; p.ffn_w2 = (const float*)d_in[6]; p.attn_w_in = (const float*)d_in[7]; p.attn_w_out = (const float*)d_in[8];
    p.pool_w_in = (const float*)d_in[9]; p.pool_w_group = (const float*)d_in[10]; p.pool_scale = (const float*)d_in[11]; p.pool_w_out = (const float*)d_in[12]; p.final_norm = (const float*)d_in[13];
    p.out = (float*)d_out; p.ws = (unsigned char*)d_ws;
#if MK_SPLIT
    for (int s = 0; s < NSTEPS; ++s) { p.ph_lo = s; p.ph_hi = s + 1; void* args[] = {&p};
        hipError_t e = hipLaunchCooperativeKernel((const void*)fwd_megakernel, dim3(grid), dim3(512), args, LDS_BYTES, stream);
        if (e != hipSuccess) { fprintf(stderr, "kernel_launch: launch %d failed: %s\n", s, hipGetErrorString(e)); break; } }
#else
    p.ph_lo = 0; p.ph_hi = NSTEPS; void* args[] = {&p};
    hipError_t e = hipLaunchCooperativeKernel((const void*)fwd_megakernel, dim3(grid), dim3(512), args, LDS_BYTES, stream);
    if (e != hipSuccess) fprintf(stderr, "kernel_launch: cooperative launch failed: %s (grid %d)\n", hipGetErrorString(e), grid);
#endif
}
```
